# Optimizing an MI355X kernel written in HIP

```python
import jax, jax.numpy as jnp
from jax import lax
import numpy as np

D_MODEL = 1024
BATCH = 32
SEQ = 256
DEPTH = 1
DEC_BATCH = 2
DEC_SEQ = 4096
PAST_LEN = 256

GRID_W = 64
D_RNN = 1024
N_RG_HEADS = 16
RG_HEAD_DIM = D_RNN // N_RG_HEADS
RG_CONV_W = 4
RG_CONV_PAD = 2
C_RG = 8.0
D_CONV = 1024
SC_CONV_W = 3
D_FF = 4 * D_MODEL
D_IN = 2 * D_RNN + 3 * D_CONV + 2 * D_MODEL
EPS = 1e-6

kernel_name = "hybrid_rglru_shortconv_diffusion_step"


def _rmsnorm(x, g):
    xf = x.astype(jnp.float32)
    r = lax.rsqrt(jnp.mean(jnp.square(xf), axis=-1, keepdims=True) + EPS)
    return (xf * r).astype(x.dtype) * g


def _dwconv(x, w, pad_left, b=None):
    K = w.shape[0]
    L = x.shape[1]
    xp = jnp.pad(x, ((0, 0), (pad_left, K - 1 - pad_left), (0, 0)))
    y = xp[:, 0:L] * w[0]
    for k in range(1, K):
        y = y + xp[:, k:k + L] * w[k]
    return y if b is None else y + b


def _seq_conv(x, w, pad_left, on_grid, b=None):
    if on_grid:
        B, L, C = x.shape
        rows = L // GRID_W
        y = _dwconv(x.reshape(B * rows, GRID_W, C), w, pad_left, b)
        return y.reshape(B, L, C)
    return _dwconv(x, w, pad_left, b)


def _lin_combine(e1, e2):
    a1, b1 = e1
    a2, b2 = e2
    return a1 * a2, a2 * b1 + b2


def _rglru_dir(x, h0, wa, ba, wx, bx, lam, reverse):
    B, L, _ = x.shape
    xh = x.reshape(B, L, N_RG_HEADS, RG_HEAD_DIM)
    r = jax.nn.sigmoid(jnp.einsum('blhi,hij->blhj', xh, wa).reshape(B, L, D_RNN) + ba)
    i = jax.nn.sigmoid(jnp.einsum('blhi,hij->blhj', xh, wx).reshape(B, L, D_RNN) + bx)
    log_a = (-C_RG * r.astype(jnp.float32)) * jax.nn.softplus(-lam.astype(jnp.float32))
    a = jnp.exp(log_a)
    u = jnp.sqrt(-jnp.expm1(2.0 * log_a)) * (i * x).astype(jnp.float32)
    A, Bc = lax.associative_scan(_lin_combine, (a, u), axis=1, reverse=reverse)
    h = A * h0.astype(jnp.float32)[:, None, :] + Bc
    final = h[:, 0] if reverse else h[:, -1]
    return h.astype(x.dtype), final.astype(x.dtype)


def _block(x, s_act, h0, on_grid, ada_w, ada_b, norm1_g, norm2_g, w_in, b_gate,
           conv_rg_w, conv_rg_b, rg_wa, rg_ba, rg_wx, rg_bx, rg_lam, w_rg_out,
           conv_sc_w, w_sc_out, w_o, w_mlp1, w_mlp2):
    mod = (s_act @ ada_w + ada_b)[:, None, :]
    sh1, sc1, g1, sh2, sc2, g2 = jnp.split(mod, 6, axis=-1)
    h = _rmsnorm(x, norm1_g) * (1.0 + sc1) + sh1
    proj = h @ w_in
    xr, gr, sb, scg, sx, gates = jnp.split(
        proj, [D_RNN, 2 * D_RNN, 2 * D_RNN + D_CONV, 2 * D_RNN + 2 * D_CONV, 2 * D_RNN + 3 * D_CONV], axis=-1)
    xr = _seq_conv(xr, conv_rg_w, RG_CONV_PAD, on_grid, conv_rg_b)
    hf, fin_f = _rglru_dir(xr, h0[:, 0], rg_wa[0], rg_ba[0], rg_wx[0], rg_bx[0], rg_lam[0], False)
    hb, fin_b = _rglru_dir(xr, h0[:, 1], rg_wa[1], rg_ba[1], rg_wx[1], rg_bx[1], rg_lam[1], True)
    ya = ((hf + hb) * jax.nn.gelu(gr)) @ w_rg_out
    yb = (sb * _seq_conv(scg * sx, conv_sc_w, 1, on_grid)) @ w_sc_out
    gA, gB = jnp.split(jax.nn.sigmoid(gates + b_gate), 2, axis=-1)
    x = x + g1 * ((gA * ya + gB * yb) @ w_o)
    h = _rmsnorm(x, norm2_g) * (1.0 + sc2) + sh2
    x = x + g2 * (jnp.square(jax.nn.relu(h @ w_mlp1)) @ w_mlp2)
    return x, jnp.stack([fin_f, fin_b], axis=1)


def setup_inputs(seed: int = 0) -> dict:
    key = jax.random.key(seed)
    ks = jax.random.split(key, 28)
    f32 = jnp.float32
    nrm = lambda k, s, sc: jax.random.normal(k, s, f32) * sc
    a0 = jax.random.uniform(ks[16], (DEPTH, 2, D_RNN), f32, 0.9, 0.999)
    return {
        "x_prompt": nrm(ks[0], (BATCH, SEQ, D_MODEL), 1.0),
        "x_sample": nrm(ks[1], (DEC_BATCH, DEC_SEQ, D_MODEL), 1.0),
        "state_rglru": nrm(ks[2], (DEC_BATCH, DEPTH, 2, D_RNN), 0.5),
        "c": nrm(ks[3], (DEC_BATCH, D_MODEL), 1.0),
        "c_ctx": nrm(ks[4], (D_MODEL,), 1.0),
        "ada_w": nrm(ks[5], (DEPTH, D_MODEL, 6 * D_MODEL), D_MODEL ** -0.5),
        "ada_b": nrm(ks[6], (DEPTH, 6 * D_MODEL), 0.02),
        "norm1_g": 1.0 + nrm(ks[7], (DEPTH, D_MODEL), 0.02),
        "norm2_g": 1.0 + nrm(ks[8], (DEPTH, D_MODEL), 0.02),
        "w_in": nrm(ks[9], (DEPTH, D_MODEL, D_IN), D_MODEL ** -0.5),
        "b_gate": nrm(ks[10], (DEPTH, 2 * D_MODEL), 0.02),
        "conv_rg_w": nrm(ks[11], (DEPTH, RG_CONV_W, D_RNN), RG_CONV_W ** -0.5),
        "conv_rg_b": nrm(ks[12], (DEPTH, D_RNN), 0.02),
        "rg_wa": nrm(ks[13], (DEPTH, 2, N_RG_HEADS, RG_HEAD_DIM, RG_HEAD_DIM), RG_HEAD_DIM ** -0.5),
        "rg_ba": nrm(ks[14], (DEPTH, 2, D_RNN), 0.02),
        "rg_wx": nrm(ks[15], (DEPTH, 2, N_RG_HEADS, RG_HEAD_DIM, RG_HEAD_DIM), RG_HEAD_DIM ** -0.5),
        "rg_bx": nrm(ks[17], (DEPTH, 2, D_RNN), 0.02),
        "rg_lam": jnp.log(a0 / (1.0 - a0)),
        "w_rg_out": nrm(ks[18], (DEPTH, D_RNN, D_MODEL), D_RNN ** -0.5),
        "conv_sc_w": nrm(ks[19], (DEPTH, SC_CONV_W, D_CONV), SC_CONV_W ** -0.5),
        "w_sc_out": nrm(ks[20], (DEPTH, D_CONV, D_MODEL), D_CONV ** -0.5),
        "w_o": nrm(ks[21], (DEPTH, D_MODEL, D_MODEL), D_MODEL ** -0.5),
        "w_mlp1": nrm(ks[22], (DEPTH, D_MODEL, D_FF), D_MODEL ** -0.5),
        "w_mlp2": nrm(ks[23], (DEPTH, D_FF, D_MODEL), D_FF ** -0.5),
        "final_g": 1.0 + nrm(ks[24], (D_MODEL,), 0.02),
    }


def reference(x_prompt, x_sample, state_rglru, c, c_ctx, ada_w, ada_b, norm1_g, norm2_g,
              w_in, b_gate, conv_rg_w, conv_rg_b, rg_wa, rg_ba, rg_wx, rg_bx, rg_lam,
              w_rg_out, conv_sc_w, w_sc_out, w_o, w_mlp1, w_mlp2, final_g):
    s_ctx = jax.nn.silu(c_ctx)[None, :]
    s_lat = jax.nn.silu(c)

    y_p = x_prompt
    h0_ctx = jnp.zeros((x_prompt.shape[0], 2, D_RNN), x_prompt.dtype)
    finals = []
    for l in range(DEPTH):
        y_p, fin = _block(y_p, s_ctx, h0_ctx, False, ada_w[l], ada_b[l], norm1_g[l], norm2_g[l],
                          w_in[l], b_gate[l], conv_rg_w[l], conv_rg_b[l], rg_wa[l], rg_ba[l],
                          rg_wx[l], rg_bx[l], rg_lam[l], w_rg_out[l], conv_sc_w[l], w_sc_out[l],
                          w_o[l], w_mlp1[l], w_mlp2[l])
        finals.append(fin)
    new_state_rglru = jnp.stack(finals, axis=1)

    y_s = x_sample
    for l in range(DEPTH):
        y_s, _ = _block(y_s, s_lat, state_rglru[:, l], True, ada_w[l], ada_b[l], norm1_g[l], norm2_g[l],
                        w_in[l], b_gate[l], conv_rg_w[l], conv_rg_b[l], rg_wa[l], rg_ba[l],
                        rg_wx[l], rg_bx[l], rg_lam[l], w_rg_out[l], conv_sc_w[l], w_sc_out[l],
                        w_o[l], w_mlp1[l], w_mlp2[l])

    y_prompt = _rmsnorm(y_p, final_g)
    y_sample = _rmsnorm(y_s, final_g)
    return (y_prompt, y_sample, new_state_rglru)
```

```cpp
#include <hip/hip_runtime.h>
#include <cstdio>

namespace nv {
constexpr int D = 1024, DIN = 7168, DFF = 4096, NTOK = 16384, CH = 4096  ;

__device__ __forceinline__ float sigm(float v) { return 1.f / (1.f + expf(-v)); }

__global__ void k_mod(const float* c, const float* c_ctx, const float* ada_w, const float* ada_b, float* mod) {
    const int col = blockIdx.x * 256 + threadIdx.x, row = blockIdx.y;
    const float* src = row == 0 ? c_ctx : c + (row - 1) * D;
    float acc = 0.f;
    for (int k = 0; k < D; ++k) { const float v = src[k]; acc += (v * sigm(v)) * ada_w[(size_t)k * 6144 + col]; }
    mod[row * 6144 + col] = acc + ada_b[col];
}
__device__ __forceinline__ int mod_row(int m) { return m < 8192 ? 0 : 1 + ((m - 8192) >> 12); }

__device__ float block_sum256(float v, float* red) {
    for (int o = 32; o >= 1; o >>= 1) v += __shfl_xor(v, o);
    __syncthreads();
    if ((threadIdx.x & 63) == 0) red[threadIdx.x >> 6] = v;
    __syncthreads();
    return red[0] + red[1] + red[2] + red[3];
}
__global__ void k_norm_mod(const float* x, int m0, const float* g, const float* mod, int sh_off, int sc_off, float* h) {
    __shared__ float red[4];
    const int r = blockIdx.x, m = m0 + r; const float* xr = x + (size_t)r * D;
    float v[4], s = 0.f;
    for (int j = 0; j < 4; ++j) { v[j] = xr[threadIdx.x + 256 * j]; s += v[j] * v[j]; }
    const float tot = block_sum256(s, red), rs = rsqrtf(tot / D + 1e-6f);
    const float* mr = mod + mod_row(m) * 6144;
    for (int j = 0; j < 4; ++j) { const int c = threadIdx.x + 256 * j; h[(size_t)r * D + c] = (v[j] * rs) * g[c] * (1.f + mr[sc_off + c]) + mr[sh_off + c]; }
}
__global__ void __launch_bounds__(256) k_gemm(const float* A, int lda, const float* B, int ldb, float* C, int ldc, int K) {
    __shared__ float As[16][65], Bs[16][65];
    const int tx = threadIdx.x & 15, ty = threadIdx.x >> 4, m0 = blockIdx.y * 64, n0 = blockIdx.x * 64;
    float acc[4][4] = {};
    for (int k0 = 0; k0 < K; k0 += 16) {
        for (int i = threadIdx.x; i < 1024; i += 256) { const int r = i >> 4, kk = i & 15; As[kk][r] = A[(size_t)(m0 + r) * lda + k0 + kk]; }
        for (int i = threadIdx.x; i < 1024; i += 256) { const int kk = i >> 6, cc = i & 63; Bs[kk][cc] = B[(size_t)(k0 + kk) * ldb + n0 + cc]; }
        __syncthreads();
#pragma unroll
        for (int kk = 0; kk < 16; ++kk) {
            float a[4], b[4];
#pragma unroll
            for (int i = 0; i < 4; ++i) { a[i] = As[kk][ty * 4 + i]; b[i] = Bs[kk][tx * 4 + i]; }
#pragma unroll
            for (int i = 0; i < 4; ++i)
#pragma unroll
                for (int j = 0; j < 4; ++j) acc[i][j] += a[i] * b[j];
        }
        __syncthreads();
    }
    for (int i = 0; i < 4; ++i) for (int j = 0; j < 4; ++j) C[(size_t)(m0 + ty * 4 + i) * ldc + n0 + tx * 4 + j] = acc[i][j];
}
__device__ __forceinline__ void seg_of(int m0, int r, int& lo, int& hi) { if (m0 < 8192) { lo = r & ~255; hi = lo + 256; } else { lo = r & ~63; hi = lo + 64; } }
__global__ void k_conv_rg(const float* proj, int m0, const float* w, const float* b, float* xc) {
    const int r = blockIdx.x; int lo, hi; seg_of(m0, r, lo, hi);
    for (int c = threadIdx.x; c < D; c += 256) {
        float acc = b[c];
        for (int k = 0; k < 4; ++k) { const int rr = r + k - 2; if (rr >= lo && rr < hi) acc += w[k * D + c] * proj[(size_t)rr * DIN + c]; }
        xc[(size_t)r * D + c] = acc;
    }
}
__global__ void k_gates(const float* xc, const float* wa, const float* ba, const float* wx, const float* bx, const float* lam, float* a_out, float* u_out) {
    const int r = blockIdx.x, dir = blockIdx.y;
    __shared__ float xs[D];
    for (int c = threadIdx.x; c < D; c += 256) xs[c] = xc[(size_t)r * D + c];
    __syncthreads();
    for (int c = threadIdx.x; c < D; c += 256) {
        const int h = c >> 6, j = c & 63; float sa = 0.f, sx = 0.f;
        const float* wap = wa + ((size_t)(dir * 16 + h) * 64) * 64 + j; const float* wxp = wx + ((size_t)(dir * 16 + h) * 64) * 64 + j;
#pragma unroll 4
        for (int i = 0; i < 64; ++i) { const float xv = xs[h * 64 + i]; sa += xv * wap[i * 64]; sx += xv * wxp[i * 64]; }
        const float rg = sigm(sa + ba[dir * D + c]), ig = sigm(sx + bx[dir * D + c]);
        const float l = lam[dir * D + c], sp = (l < -20.f) ? -l : log1pf(expf(-l));
        const float log_a = -8.f * rg * sp;
        a_out[((size_t)dir * CH + r) * D + c] = expf(log_a);
        u_out[((size_t)dir * CH + r) * D + c] = sqrtf(-expm1f(2.f * log_a)) * (ig * xs[c]);
    }
}
__global__ void k_scan(const float* a, float* u, int seqlen, int nseq, const float* h0  , float* fin  ) {
    const int idx = blockIdx.x * 256 + threadIdx.x; const int c = idx & (D - 1), dir = (idx >> 10) & 1, s = idx >> 11;
    if (s >= nseq) return;
    float h = h0 ? h0[dir * D + c] : 0.f;
    const size_t base = ((size_t)dir * CH + (size_t)s * seqlen) * D + c;
    if (dir == 0) { for (int t = 0; t < seqlen; ++t) { const size_t o = base + (size_t)t * D; h = a[o] * h + u[o]; u[o] = h; } }
    else { for (int t = seqlen - 1; t >= 0; --t) { const size_t o = base + (size_t)t * D; h = a[o] * h + u[o]; u[o] = h; } }
    if (fin) fin[((size_t)s * 2 + dir) * D + c] = h;
}
__device__ __forceinline__ float gelu_tanh(float x) { return 0.5f * x * (1.f + tanhf(0.7978845608028654f * (x + 0.044715f * x * x * x))); }
__global__ void k_mix(const float* proj, int m0, const float* hfb, const float* wsc, float* Aa, float* Ab) {
    const int r = blockIdx.x; int lo, hi; seg_of(m0, r, lo, hi);
    for (int c = threadIdx.x; c < D; c += 256) {
        const float* pr = proj + (size_t)r * DIN;
        Aa[(size_t)r * D + c] = (hfb[(size_t)r * D + c] + hfb[((size_t)CH + r) * D + c]) * gelu_tanh(pr[D + c]);
        float acc = 0.f;
        for (int k = 0; k < 3; ++k) { const int rr = r + k - 1; if (rr >= lo && rr < hi) { const float* q = proj + (size_t)rr * DIN; acc += wsc[k * D + c] * (q[3 * D + c] * q[4 * D + c]); } }
        Ab[(size_t)r * D + c] = pr[2 * D + c] * acc;
    }
}
__global__ void k_merge(const float* proj, const float* bg, const float* ya, const float* yb, float* mm) {
    const int r = blockIdx.x; const float* pr = proj + (size_t)r * DIN + 5 * D;
    for (int c = threadIdx.x; c < D; c += 256) mm[(size_t)r * D + c] = sigm(pr[c] + bg[c]) * ya[(size_t)r * D + c] + sigm(pr[D + c] + bg[D + c]) * yb[(size_t)r * D + c];
}
__global__ void k_resid(const float* xi, int m0, const float* mod, int g_off, const float* y, float* xo) {
    const int r = blockIdx.x; const float* mr = mod + mod_row(m0 + r) * 6144 + g_off;
    for (int c = threadIdx.x; c < D; c += 256) xo[(size_t)r * D + c] = xi[(size_t)r * D + c] + mr[c] * y[(size_t)r * D + c];
}
__global__ void k_relu2(float* h, size_t n) { for (size_t i = (size_t)blockIdx.x * 256 + threadIdx.x; i < n; i += (size_t)gridDim.x * 256) { const float v = fmaxf(h[i], 0.f); h[i] = v * v; } }
__global__ void k_final(const float* x1, int m0, const float* mod, const float* y, const float* fg, float* out) {
    __shared__ float red[4];
    const int r = blockIdx.x; const float* mr = mod + mod_row(m0 + r) * 6144 + 5 * D;
    float v[4], s = 0.f;
    for (int j = 0; j < 4; ++j) { const int c = threadIdx.x + 256 * j; v[j] = x1[(size_t)r * D + c] + mr[c] * y[(size_t)r * D + c]; s += v[j] * v[j]; }
    const float tot = block_sum256(s, red), rs = rsqrtf(tot / D + 1e-6f);
    for (int j = 0; j < 4; ++j) { const int c = threadIdx.x + 256 * j; out[(size_t)r * D + c] = v[j] * rs * fg[c]; }
}
}

extern "C" void kernel_launch(void* const* d_in, const int* in_sizes, int n_in, void* d_out, int out_size, void* d_ws, size_t ws_size, hipStream_t stream) {
    using namespace nv;
    const float* x_prompt = (const float*)d_in[0]; const float* x_sample = (const float*)d_in[1]; const float* state = (const float*)d_in[2];
    const float* c = (const float*)d_in[3]; const float* c_ctx = (const float*)d_in[4]; const float* ada_w = (const float*)d_in[5]; const float* ada_b = (const float*)d_in[6];
    const float* norm1_g = (const float*)d_in[7]; const float* norm2_g = (const float*)d_in[8]; const float* w_in = (const float*)d_in[9]; const float* b_gate = (const float*)d_in[10];
    const float* conv_rg_w = (const float*)d_in[11]; const float* conv_rg_b = (const float*)d_in[12]; const float* rg_wa = (const float*)d_in[13]; const float* rg_ba = (const float*)d_in[14];
    const float* rg_wx = (const float*)d_in[15]; const float* rg_bx = (const float*)d_in[16]; const float* rg_lam = (const float*)d_in[17]; const float* w_rg_out = (const float*)d_in[18];
    const float* conv_sc_w = (const float*)d_in[19]; const float* w_sc_out = (const float*)d_in[20]; const float* w_o = (const float*)d_in[21]; const float* w_mlp1 = (const float*)d_in[22];
    const float* w_mlp2 = (const float*)d_in[23]; const float* final_g = (const float*)d_in[24];
    float* out = (float*)d_out;
    const size_t MB = 1u << 20;
    if (ws_size < 256 * MB) { fprintf(stderr, "kernel_launch: workspace too small (%zu)\n", ws_size); return; }
    char* ws = (char*)d_ws;
    float* mod = (float*)ws;
    float* PROJ = (float*)(ws + 1 * MB);
    float* B1 = (float*)(ws + 113 * MB);
    float* B2 = (float*)(ws + 129 * MB);
    float* AB = (float*)(ws + 145 * MB);
    float* UB = (float*)(ws + 177 * MB);
    float* AA = (float*)(ws + 209 * MB);
    float* ABb = (float*)(ws + 225 * MB);
    float* X1 = (float*)(ws + 241 * MB);
    (void)X1;
    k_mod<<<dim3(6144 / 256, 3), 256, 0, stream>>>(c, c_ctx, ada_w, ada_b, mod);
    for (int ch = 0; ch < 4; ++ch) {
        const int m0 = ch * CH; const bool ctx = m0 < 8192;
        const float* x = ctx ? x_prompt + (size_t)m0 * D : x_sample + (size_t)(m0 - 8192) * D;
        float* o = out + (size_t)m0 * D;
        k_norm_mod<<<CH, 256, 0, stream>>>(x, m0, norm1_g, mod, 0, D, B1);
        k_gemm<<<dim3(DIN / 64, CH / 64), 256, 0, stream>>>(B1, D, w_in, DIN, PROJ, DIN, D);
        k_conv_rg<<<CH, 256, 0, stream>>>(PROJ, m0, conv_rg_w, conv_rg_b, B2);
        k_gates<<<dim3(CH, 2), 256, 0, stream>>>(B2, rg_wa, rg_ba, rg_wx, rg_bx, rg_lam, AB, UB);
        if (ctx) k_scan<<<(16 * 2 * D) / 256, 256, 0, stream>>>(AB, UB, 256, 16, nullptr, out + (size_t)NTOK * D + (size_t)(m0 / 256) * 2 * D);
        else k_scan<<<(1 * 2 * D) / 256, 256, 0, stream>>>(AB, UB, 4096, 1, state + (size_t)((m0 - 8192) / 4096) * 2 * D, nullptr);
        k_mix<<<CH, 256, 0, stream>>>(PROJ, m0, UB, conv_sc_w, AA, ABb);
        float* YA = B2; float* YB = AB;
        k_gemm<<<dim3(D / 64, CH / 64), 256, 0, stream>>>(AA, D, w_rg_out, D, YA, D, D);
        k_gemm<<<dim3(D / 64, CH / 64), 256, 0, stream>>>(ABb, D, w_sc_out, D, YB, D, D);
        k_merge<<<CH, 256, 0, stream>>>(PROJ, b_gate, YA, YB, B1);
        k_gemm<<<dim3(D / 64, CH / 64), 256, 0, stream>>>(B1, D, w_o, D, B2, D, D);
        float* X1c = UB;
        k_resid<<<CH, 256, 0, stream>>>(x, m0, mod, 2 * D, B2, X1c);
        k_norm_mod<<<CH, 256, 0, stream>>>(X1c, m0, norm2_g, mod, 3 * D, 4 * D, B1);
        float* HID = PROJ;
        k_gemm<<<dim3(DFF / 64, CH / 64), 256, 0, stream>>>(B1, D, w_mlp1, DFF, HID, DFF, D);
        k_relu2<<<2048, 256, 0, stream>>>(HID, (size_t)CH * DFF);
        k_gemm<<<dim3(D / 64, CH / 64), 256, 0, stream>>>(HID, DFF, w_mlp2, D, B2, D, DFF);
        k_final<<<CH, 256, 0, stream>>>(X1c, m0, mod, B2, final_g, o);
    }
}
```

```cpp
#include <hip/hip_runtime.h>
#include <cstdio>
#include <cstdint>
namespace pg8 {
#define PG8_LAS __attribute__((address_space(3)))
typedef unsigned short bf16_t;
typedef short bf16x8 __attribute__((ext_vector_type(8)));
typedef float f32x4 __attribute__((ext_vector_type(4)));
typedef unsigned u32x4 __attribute__((ext_vector_type(4)));
constexpr int BM = 256, BK = 64, HALF = 128, HTB = HALF * BK * 2  , STAGE_BYTES = 8 * HTB, NXCD = 8, WGM = 8;

__host__ __device__ __forceinline__ int lds_byte(int r, int c) { const int st = (r >> 4) * 2 + (c >> 5), rr = r & 15, cc = c & 31, ob = rr * 64 + cc * 2; return st * 1024 + (ob ^ (((ob >> 9) & 1) << 5)); }
__host__ __device__ __forceinline__ void stage_rc(int b, int& R, int& C) { const int st = b / 1024, sb = b % 1024, swz = sb ^ (((sb >> 9) & 1) << 5); R = (st >> 1) * 16 + swz / 64; C = (st & 1) * 32 + (swz % 64) / 2; }
__host__ __device__ __forceinline__ int perm32(int rho) { const int n = rho >> 4, i = rho & 15; return 8 * (i >> 2) + 4 * n + (i & 3); }

struct Unit { int pm, pn; };
struct Gemm { const bf16_t* A; const bf16_t* Bt; int M, N, K; };

struct StaticOrder {
    int nM, nN, nwg, G, c;
    __host__ __device__ void init(int M, int N, int G_, int c_) { nM = M / BM; nN = N / BM; nwg = nM * nN; G = G_; c = c_; }
    __host__ __device__ bool next(int i, Unit& u) const {
        const long L = (long)i * G + c; if (L >= nwg) return false;
        int wgid = (int)L; { const int q = nwg / NXCD, r = nwg % NXCD, xcd = wgid % NXCD, off = wgid / NXCD; wgid = (xcd < r ? xcd * (q + 1) : r * (q + 1) + (xcd - r) * q) + off; }
        const int nig = WGM * nN, gid = wgid / nig, fm = gid * WGM, gsz = (nM - fm) < WGM ? (nM - fm) : WGM;
        u.pm = fm + ((wgid % nig) % gsz); u.pn = (wgid % nig) / gsz; return true;
    }
    __device__ __forceinline__ void a_ready(const Unit&) const {}
    __device__ __forceinline__ void done(const Unit&) const {}
};
typedef float f32x2c_t __attribute__((ext_vector_type(2))); typedef __bf16 bf16x2c_t __attribute__((ext_vector_type(2)));
__device__ __forceinline__ unsigned cvt_pk_bf16(float lo, float hi) { const f32x2c_t v = {lo, hi}; const bf16x2c_t b = __builtin_convertvector(v, bf16x2c_t); return __builtin_bit_cast(unsigned, b); }
typedef float f32x2 __attribute__((ext_vector_type(2)));
__device__ __forceinline__ float bf_lo(unsigned w) { return __uint_as_float(w << 16); }
__device__ __forceinline__ float bf_hi(unsigned w) { return __uint_as_float(w & 0xffff0000u); }
__device__ __forceinline__ float fast_sigmoid(float v) { return __builtin_amdgcn_rcpf(1.f + __builtin_amdgcn_exp2f(-1.4426950408889634f * v)); }
__device__ __forceinline__ float gelu_t(float x) { const float z2 = x * (1.5957691216057308f + 0.0713548162726002f * x * x); return x * fast_sigmoid(z2); }
__device__ __forceinline__ u32x4 pack8(const f32x4 v0, const f32x4 v1) { u32x4 w; w.x = cvt_pk_bf16(v0[0], v0[1]); w.y = cvt_pk_bf16(v0[2], v0[3]); w.z = cvt_pk_bf16(v1[0], v1[1]); w.w = cvt_pk_bf16(v1[2], v1[3]); return w; }
__device__ __forceinline__ int mod_row_of_tile(int pm) { return pm < 32 ? 0 : 1 + ((pm - 32) >> 4); }
constexpr int DMODEL = 1024;

struct EpiG1 {
    static constexpr bool PERM = true, AFTER_DRAIN = false;
    bf16_t *XR, *GGR, *SB, *T, *GATES; const float* b_gate;
    template <bool ACT> static __device__ __forceinline__ void plain(const f32x4 (&acc)[2][2][4][2], bf16_t* base, int row0, int col0) {
#pragma unroll
        for (int ai = 0; ai < 2; ++ai)
#pragma unroll
            for (int m = 0; m < 4; ++m) { bf16_t* rowp = base + (size_t)(row0 + ai * HALF + m * 16) * DMODEL + col0;
#pragma unroll
                for (int bj = 0; bj < 2; ++bj) { f32x4 v0 = acc[ai][bj][m][0], v1 = acc[ai][bj][m][1];
                    if (ACT) {
#pragma unroll
                        for (int j = 0; j < 4; ++j) { v0[j] = gelu_t(v0[j]); v1[j] = gelu_t(v1[j]); } }
                    *(u32x4*)(rowp + bj * HALF) = pack8(v0, v1); } }
    }
    __device__ __forceinline__ void operator()(const f32x4 (&acc)[2][2][4][2], const Unit& u, int wr, int wc, int fr, int fq) const {
        const int row0 = u.pm * BM + wr * 64 + fr, pn = u.pn, cw = wc * 32 + 8 * fq;
        if (pn < 4) plain<false>(acc, XR, row0, pn * BM + cw);
        else if (pn < 8) plain<true>(acc, GGR, row0, (pn - 4) * BM + cw);
        else if (pn < 12) plain<false>(acc, SB, row0, (pn - 8) * BM + cw);
        else if (pn < 20) {
            const int col0 = (pn - 12) * 128 + cw;
#pragma unroll
            for (int ai = 0; ai < 2; ++ai)
#pragma unroll
                for (int m = 0; m < 4; ++m) { bf16_t* rowp = T + (size_t)(row0 + ai * HALF + m * 16) * DMODEL + col0;
                    *(u32x4*)rowp = pack8(acc[ai][0][m][0] * acc[ai][1][m][0], acc[ai][0][m][1] * acc[ai][1][m][1]); }
        } else {
            const int col0 = (pn - 20) * BM + cw;
            f32x4 bv[2][2];
#pragma unroll
            for (int bj = 0; bj < 2; ++bj)
#pragma unroll
                for (int n = 0; n < 2; ++n) bv[bj][n] = *(const f32x4*)(b_gate + col0 + bj * HALF + 4 * n);
#pragma unroll
            for (int ai = 0; ai < 2; ++ai)
#pragma unroll
                for (int m = 0; m < 4; ++m) { bf16_t* rowp = GATES + (size_t)(row0 + ai * HALF + m * 16) * 2048 + col0;
#pragma unroll
                    for (int bj = 0; bj < 2; ++bj) { f32x4 v0 = acc[ai][bj][m][0] + bv[bj][0], v1 = acc[ai][bj][m][1] + bv[bj][1];
#pragma unroll
                        for (int j = 0; j < 4; ++j) { v0[j] = fast_sigmoid(v0[j]); v1[j] = fast_sigmoid(v1[j]); }
                        *(u32x4*)(rowp + bj * HALF) = pack8(v0, v1); } }
        }
    }
};

struct EpiG2 {
    static constexpr bool PERM = true, AFTER_DRAIN = false;
    const bf16_t* GATES; float* PA; bf16_t* MB;
    __device__ __forceinline__ void operator()(const f32x4 (&acc)[2][2][4][2], const Unit& u, int wr, int wc, int fr, int fq) const {
        const bool second = u.pm >= 64; const int pm = u.pm & 63, pn = u.pn & 3;
        const int row0 = pm * BM + wr * 64 + fr, col0 = pn * BM + wc * 32 + 8 * fq;
#pragma unroll
        for (int ai = 0; ai < 2; ++ai)
#pragma unroll
            for (int m = 0; m < 4; ++m) { const size_t row = (size_t)(row0 + ai * HALF + m * 16);
#pragma unroll
                for (int bj = 0; bj < 2; ++bj) { const int col = col0 + bj * HALF;
                    const u32x4 gw = *(const u32x4*)(GATES + row * 2048 + (second ? 1024 : 0) + col);
                    f32x4 v0 = acc[ai][bj][m][0], v1 = acc[ai][bj][m][1];
                    v0[0] *= bf_lo(gw.x); v0[1] *= bf_hi(gw.x); v0[2] *= bf_lo(gw.y); v0[3] *= bf_hi(gw.y);
                    v1[0] *= bf_lo(gw.z); v1[1] *= bf_hi(gw.z); v1[2] *= bf_lo(gw.w); v1[3] *= bf_hi(gw.w);
                    float* pp = PA + row * DMODEL + col;
                    if (!second) { *(f32x4*)pp = v0; *(f32x4*)(pp + 4) = v1; }
                    else { v0 += *(const f32x4*)pp; v1 += *(const f32x4*)(pp + 4); *(u32x4*)(MB + row * DMODEL + col) = pack8(v0, v1); } }
                asm volatile("" ::: "memory"); }
    }
};

struct EpiG3 {
    static constexpr bool PERM = true, AFTER_DRAIN = false;
    const float *XP, *XS, *mod, *gmod2; float* X1; bf16_t* A2; float* SSQ;
    __device__ __forceinline__ void operator()(const f32x4 (&acc)[2][2][4][2], const Unit& u, int wr, int wc, int fr, int fq) const {
        const int pm = u.pm, mbi = mod_row_of_tile(pm);
        const float* xb = pm < 32 ? XP + (size_t)pm * BM * DMODEL : XS + (size_t)(pm - 32) * BM * DMODEL;
        const int rl0 = wr * 64 + fr, col0 = u.pn * BM + wc * 32 + 8 * fq;
        f32x4 g1v[2][2], gm[2][2];
#pragma unroll
        for (int bj = 0; bj < 2; ++bj)
#pragma unroll
            for (int n = 0; n < 2; ++n) { g1v[bj][n] = *(const f32x4*)(mod + mbi * 6144 + 2 * DMODEL + col0 + bj * HALF + 4 * n); gm[bj][n] = *(const f32x4*)(gmod2 + mbi * DMODEL + col0 + bj * HALF + 4 * n); }
#pragma unroll
        for (int ai = 0; ai < 2; ++ai)
#pragma unroll
            for (int m = 0; m < 4; ++m) { const int rl = rl0 + ai * HALF + m * 16; const size_t row = (size_t)pm * BM + rl; float ss = 0.f;
#pragma unroll
                for (int bj = 0; bj < 2; ++bj) { f32x4 x1[2];
#pragma unroll
                    for (int n = 0; n < 2; ++n) { const f32x4 xv = *(const f32x4*)(xb + (size_t)rl * DMODEL + col0 + bj * HALF + 4 * n);
                        x1[n] = xv + g1v[bj][n] * acc[ai][bj][m][n];
                        *(f32x4*)(X1 + row * DMODEL + col0 + bj * HALF + 4 * n) = x1[n];
                        ss += (x1[n][0] * x1[n][0] + x1[n][1] * x1[n][1]) + (x1[n][2] * x1[n][2] + x1[n][3] * x1[n][3]); }
                    *(u32x4*)(A2 + row * DMODEL + col0 + bj * HALF) = pack8(x1[0] * gm[bj][0], x1[1] * gm[bj][1]); }
                ss += __shfl_xor(ss, 16); ss += __shfl_xor(ss, 32);
                if (fq == 0) SSQ[row * 16 + u.pn * 4 + wc] = ss;
                asm volatile("" ::: "memory"); }
    }
};

struct EpiG4 {
    static constexpr bool PERM = true, AFTER_DRAIN = false;
    const float *SSQ, *bias2; bf16_t* HID;
    __device__ __forceinline__ void operator()(const f32x4 (&acc)[2][2][4][2], const Unit& u, int wr, int wc, int fr, int fq) const {
        const int pm = u.pm, mbi = mod_row_of_tile(pm);
        const int row0 = pm * BM + wr * 64 + fr, col0 = u.pn * BM + wc * 32 + 8 * fq;
        f32x4 bv[2][2];
#pragma unroll
        for (int bj = 0; bj < 2; ++bj)
#pragma unroll
            for (int n = 0; n < 2; ++n) bv[bj][n] = *(const f32x4*)(bias2 + mbi * 4096 + col0 + bj * HALF + 4 * n);
#pragma unroll
        for (int ai = 0; ai < 2; ++ai)
#pragma unroll
            for (int m = 0; m < 4; ++m) { const size_t row = (size_t)(row0 + ai * HALF + m * 16);
                const f32x4* sp = (const f32x4*)(SSQ + row * 16); const f32x4 s0 = sp[0], s1 = sp[1], s2 = sp[2], s3 = sp[3];
                const float tot = ((s0[0] + s0[1]) + (s0[2] + s0[3])) + ((s1[0] + s1[1]) + (s1[2] + s1[3])) + ((s2[0] + s2[1]) + (s2[2] + s2[3])) + ((s3[0] + s3[1]) + (s3[2] + s3[3]));
                const float rs = __builtin_amdgcn_rsqf(tot * (1.f / 1024.f) + 1e-6f);
#pragma unroll
                for (int bj = 0; bj < 2; ++bj) { f32x4 v0 = acc[ai][bj][m][0] * rs + bv[bj][0], v1 = acc[ai][bj][m][1] * rs + bv[bj][1];
#pragma unroll
                    for (int j = 0; j < 4; ++j) { const float a = fmaxf(v0[j], 0.f), b = fmaxf(v1[j], 0.f); v0[j] = a * a; v1[j] = b * b; }
                    *(u32x4*)(HID + row * 4096 + col0 + bj * HALF) = pack8(v0, v1); }
                asm volatile("" ::: "memory"); }
    }
};

struct EpiG5 {
    static constexpr bool PERM = true, AFTER_DRAIN = false;
    float* X; const float* mod; float* SSQ;
    __device__ __forceinline__ void operator()(const f32x4 (&acc)[2][2][4][2], const Unit& u, int wr, int wc, int fr, int fq) const {
        const int pm = u.pm, mbi = mod_row_of_tile(pm);
        const int row0 = pm * BM + wr * 64 + fr, col0 = u.pn * BM + wc * 32 + 8 * fq;
        f32x4 g2v[2][2];
#pragma unroll
        for (int bj = 0; bj < 2; ++bj)
#pragma unroll
            for (int n = 0; n < 2; ++n) g2v[bj][n] = *(const f32x4*)(mod + mbi * 6144 + 5 * DMODEL + col0 + bj * HALF + 4 * n);
#pragma unroll
        for (int ai = 0; ai < 2; ++ai)
#pragma unroll
            for (int m = 0; m < 4; ++m) { const size_t row = (size_t)(row0 + ai * HALF + m * 16); float ss = 0.f;
#pragma unroll
                for (int bj = 0; bj < 2; ++bj)
#pragma unroll
                    for (int n = 0; n < 2; ++n) { float* p = X + row * DMODEL + col0 + bj * HALF + 4 * n; const f32x4 x2 = *(const f32x4*)p + g2v[bj][n] * acc[ai][bj][m][n]; *(f32x4*)p = x2;
                        ss += (x2[0] * x2[0] + x2[1] * x2[1]) + (x2[2] * x2[2] + x2[3] * x2[3]); }
                ss += __shfl_xor(ss, 16); ss += __shfl_xor(ss, 32);
                if (fq == 0) SSQ[row * 16 + u.pn * 4 + wc] = ss;
                asm volatile("" ::: "memory"); }
    }
};

struct PairOrder {
    StaticOrder base;
    __device__ __forceinline__ bool next(int i, Unit& u) const { Unit t; if (!base.next(i >> 1, t)) return false; const int o = i & 1; u.pm = t.pm + 64 * o; u.pn = t.pn + 4 * o; return true; }
    __device__ __forceinline__ void a_ready(const Unit&) const {}
    __device__ __forceinline__ void done(const Unit&) const {}
};
template <class Epi, class Sched, bool ALIGN_EPI = false, bool SP2 = false>
__device__ __forceinline__ void gemm_phase(PG8_LAS unsigned char* lds, const Gemm g, const Sched& S, const Epi& E) {
    const int tid = threadIdx.x, wid = __builtin_amdgcn_readfirstlane(tid >> 6), lane = tid & 63, wr = wid >> 2, wc = wid & 3, fr = lane & 15, fq = lane >> 4;
    const int K = g.K, nt = K / BK;
    unsigned voffA[2], voffB[2];
#pragma unroll
    for (int i = 0; i < 2; ++i) { int R, C; stage_rc(tid * 16 + i * 8192, R, C); const int Rb = Epi::PERM ? ((R & ~31) + perm32(R & 31)) : R;
        voffA[i] = (unsigned)(R * K + C) * 2u; voffB[i] = (unsigned)(Rb * K + C) * 2u; }
    const size_t kstep = (size_t)(BK * 2);
    const size_t hstep = (size_t)HALF * K * 2;
    const size_t tstep = 2 * hstep;
    const unsigned ldsw = (unsigned)wid * 1024u;
    const int aoff = lds_byte(wr * 64 + fr, fq * 8), boff = lds_byte(wc * 32 + fr, fq * 8);
#define PG8_SA(b, h) (((b) * 2 + (h)) * HTB)
#define PG8_SB(b, h) ((4 + (b) * 2 + (h)) * HTB)
#define PG8_STAGE(bufoff, gbase, voff) do { _Pragma("unroll") for (int _i = 0; _i < 2; ++_i) \
        __builtin_amdgcn_global_load_lds((const unsigned*)((const char*)(gbase) + (voff)[_i]), (PG8_LAS unsigned*)(lds + (bufoff) + ldsw + _i * 8192), 16, 0, 0); } while (0)
#define PG8_LDA(dst, b, h) do { _Pragma("unroll") for (int m = 0; m < 4; ++m) _Pragma("unroll") for (int k = 0; k < 2; ++k) dst[m][k] = *(const PG8_LAS bf16x8*)(lds + PG8_SA(b, h) + aoff + m * 2048 + k * 1024); } while (0)
#define PG8_LDB(dst, b, h) do { _Pragma("unroll") for (int n = 0; n < 2; ++n) _Pragma("unroll") for (int k = 0; k < 2; ++k) dst[n][k] = *(const PG8_LAS bf16x8*)(lds + PG8_SB(b, h) + boff + n * 2048 + k * 1024); } while (0)
#define PG8_MMA(ai, bj, At, Bt) do { __builtin_amdgcn_s_setprio(1); _Pragma("unroll") for (int m = 0; m < 4; ++m) _Pragma("unroll") for (int n = 0; n < 2; ++n) _Pragma("unroll") for (int k = 0; k < 2; ++k) \
        acc[ai][bj][m][n] = __builtin_amdgcn_mfma_f32_16x16x32_bf16(Bt[n][k], At[m][k], acc[ai][bj][m][n], 0, 0, 0); __builtin_amdgcn_s_setprio(0); } while (0)
#define PG8_WAIT_V(n) asm volatile("s_waitcnt vmcnt(" #n ")" ::: "memory")
#define PG8_WAIT_L(n) asm volatile("s_waitcnt lgkmcnt(" #n ")" ::: "memory")
#define PG8_BAR __builtin_amdgcn_s_barrier()
#define PG8_SCHED __builtin_amdgcn_sched_barrier(0)
    Unit cur, nxt; int ui = 0;
    if (!S.next(0, cur)) return;
    f32x4 acc[2][2][4][2];
#pragma unroll
    for (int a = 0; a < 2; ++a)
#pragma unroll
        for (int b = 0; b < 2; ++b)
#pragma unroll
            for (int m = 0; m < 4; ++m)
#pragma unroll
                for (int n = 0; n < 2; ++n) acc[a][b][m][n] = (f32x4){0.f, 0.f, 0.f, 0.f};
    bf16x8 At[4][2], B0[2][2], B1[2][2];
    const char* cA = (const char*)g.A + (size_t)cur.pm * tstep; const char* cB = (const char*)g.Bt + (size_t)cur.pn * tstep;
    S.a_ready(cur);
    if constexpr (SP2) {
        PG8_STAGE(PG8_SB(0, 0), cB, voffB); PG8_STAGE(PG8_SB(0, 1), cB + hstep, voffB); PG8_STAGE(PG8_SA(0, 0), cA, voffA); PG8_STAGE(PG8_SA(0, 1), cA + hstep, voffA);
        if (wr == 1) PG8_BAR;
        PG8_WAIT_V(2); PG8_BAR;
        PG8_STAGE(PG8_SB(1, 0), cB + kstep, voffB); PG8_STAGE(PG8_SA(1, 0), cA + kstep, voffA); PG8_STAGE(PG8_SB(1, 1), cB + hstep + kstep, voffB);
        PG8_WAIT_V(6); PG8_BAR;
    } else {
        PG8_STAGE(PG8_SB(0, 0), cB, voffB); PG8_STAGE(PG8_SA(0, 0), cA, voffA); PG8_STAGE(PG8_SB(0, 1), cB + hstep, voffB); PG8_STAGE(PG8_SA(0, 1), cA + hstep, voffA);
        if (wr == 1) PG8_BAR;
        PG8_WAIT_V(4); PG8_BAR;
        PG8_STAGE(PG8_SB(1, 0), cB + kstep, voffB); PG8_STAGE(PG8_SA(1, 0), cA + kstep, voffA); PG8_STAGE(PG8_SB(1, 1), cB + hstep + kstep, voffB);
        PG8_WAIT_V(6); PG8_BAR;
    }
    for (;;) {
        const bool has_next = S.next(ui + 1, nxt);
        const char* nA = has_next ? (const char*)g.A + (size_t)nxt.pm * tstep : cA; const char* nB = has_next ? (const char*)g.Bt + (size_t)nxt.pn * tstep : cB;
        for (int t = 0; t < nt; t += 2) {
            const bool last = (t == nt - 2);
            const char* a1 = cA + (size_t)(t + 1) * kstep;
            const char* a2 = last ? nA : cA + (size_t)(t + 2) * kstep; const char* b2 = last ? nB : cB + (size_t)(t + 2) * kstep;
            const char* a3 = a2 + kstep; const char* b3 = b2 + kstep;
            if (last && has_next) S.a_ready(nxt);
            if constexpr (SP2) {
            PG8_LDB(B0, 0, 0); PG8_LDB(B1, 0, 1); PG8_SCHED; PG8_LDA(At, 0, 0); PG8_STAGE(PG8_SA(1, 1), a1 + hstep, voffA);
            PG8_WAIT_V(8); PG8_WAIT_L(0); PG8_BAR; PG8_MMA(0, 0, At, B0); PG8_MMA(0, 1, At, B1); PG8_BAR; PG8_SCHED;
            PG8_LDA(At, 0, 1); PG8_STAGE(PG8_SB(0, 0), b2, voffB); PG8_STAGE(PG8_SB(0, 1), b2 + hstep, voffB); PG8_STAGE(PG8_SA(0, 0), a2, voffA);
            PG8_WAIT_V(8); PG8_WAIT_L(0); PG8_BAR; PG8_MMA(1, 0, At, B0); PG8_MMA(1, 1, At, B1); PG8_BAR; PG8_SCHED;
            PG8_LDB(B0, 1, 0); PG8_LDB(B1, 1, 1); PG8_SCHED; PG8_LDA(At, 1, 0); PG8_STAGE(PG8_SA(0, 1), a2 + hstep, voffA);
            PG8_WAIT_V(8); PG8_WAIT_L(0); PG8_BAR; PG8_MMA(0, 0, At, B0); PG8_MMA(0, 1, At, B1); PG8_BAR; PG8_SCHED;
            PG8_LDA(At, 1, 1); PG8_STAGE(PG8_SB(1, 0), b3, voffB); PG8_STAGE(PG8_SB(1, 1), b3 + hstep, voffB); PG8_STAGE(PG8_SA(1, 0), a3, voffA);
            PG8_WAIT_V(8); PG8_WAIT_L(0); PG8_BAR; PG8_MMA(1, 0, At, B0); PG8_MMA(1, 1, At, B1); PG8_BAR; PG8_SCHED;
            } else {
            PG8_LDB(B0, 0, 0); PG8_SCHED; PG8_LDA(At, 0, 0); PG8_STAGE(PG8_SA(1, 1), a1 + hstep, voffA);
            PG8_WAIT_L(8); PG8_BAR; PG8_WAIT_L(0); PG8_MMA(0, 0, At, B0); PG8_BAR; PG8_SCHED;
            PG8_LDB(B1, 0, 1); PG8_STAGE(PG8_SB(0, 0), b2, voffB);
            PG8_BAR; PG8_WAIT_L(0); PG8_MMA(0, 1, At, B1); PG8_BAR;
            PG8_LDA(At, 0, 1); PG8_STAGE(PG8_SA(0, 0), a2, voffA);
            PG8_BAR; PG8_WAIT_L(0); PG8_MMA(1, 0, At, B0); PG8_BAR; PG8_SCHED;
            PG8_STAGE(PG8_SB(0, 1), b2 + hstep, voffB);
            PG8_WAIT_V(6); PG8_BAR; PG8_MMA(1, 1, At, B1); PG8_BAR;
            PG8_LDB(B0, 1, 0); PG8_SCHED; PG8_LDA(At, 1, 0); PG8_STAGE(PG8_SA(0, 1), a2 + hstep, voffA);
            PG8_WAIT_L(8); PG8_BAR; PG8_WAIT_L(0); PG8_MMA(0, 0, At, B0); PG8_BAR; PG8_SCHED;
            PG8_LDB(B1, 1, 1); PG8_STAGE(PG8_SB(1, 0), b3, voffB);
            PG8_BAR; PG8_WAIT_L(0); PG8_MMA(0, 1, At, B1); PG8_BAR;
            PG8_LDA(At, 1, 1); PG8_STAGE(PG8_SA(1, 0), a3, voffA);
            PG8_BAR; PG8_WAIT_L(0); PG8_MMA(1, 0, At, B0); PG8_BAR; PG8_SCHED;
            PG8_STAGE(PG8_SB(1, 1), b3 + hstep, voffB);
            PG8_WAIT_V(6); PG8_BAR; PG8_MMA(1, 1, At, B1); PG8_BAR;
            }
        }
        if constexpr (ALIGN_EPI) { if (wr == 0) PG8_BAR; }
        if constexpr (!Epi::AFTER_DRAIN) { E(acc, cur, wr, wc, fr, fq); S.done(cur); }
        if (!has_next) break;
#pragma unroll
        for (int a = 0; a < 2; ++a)
#pragma unroll
            for (int b = 0; b < 2; ++b)
#pragma unroll
                for (int m = 0; m < 4; ++m)
#pragma unroll
                    for (int n = 0; n < 2; ++n) acc[a][b][m][n] = (f32x4){0.f, 0.f, 0.f, 0.f};
        cur = nxt; cA = nA; cB = nB; ++ui;
        if constexpr (ALIGN_EPI) { if (wr == 1) PG8_BAR; }
    }
    PG8_WAIT_V(0);
    if constexpr (!ALIGN_EPI) { if (wr == 0) PG8_BAR; }
    PG8_BAR;
    if constexpr (Epi::AFTER_DRAIN) { E.fused(acc, cur, wr, wc, fr, fq, lds, wid, lane); S.done(cur); }
#undef PG8_SA
#undef PG8_SB
#undef PG8_STAGE
#undef PG8_LDA
#undef PG8_LDB
#undef PG8_MMA
#undef PG8_WAIT_V
#undef PG8_WAIT_L
#undef PG8_BAR
#undef PG8_SCHED
}
}
#define GAS __attribute__((address_space(1)))
#define LAS __attribute__((address_space(3)))
typedef unsigned short bf16;
typedef unsigned v4u __attribute__((ext_vector_type(4)));
typedef float f32x4 __attribute__((ext_vector_type(4)));
typedef short bf16x8 __attribute__((ext_vector_type(8)));
typedef GAS unsigned gu32;
typedef GAS unsigned long long gu64;
#define RLX_AGENT __ATOMIC_RELAXED, __HIP_MEMORY_SCOPE_AGENT
#define LDS_WAIT() asm volatile("s_waitcnt lgkmcnt(0)" ::: "memory")
#define VM_WAIT() asm volatile("s_waitcnt vmcnt(0)" ::: "memory")
__device__ __forceinline__ unsigned long long rt() { return __builtin_amdgcn_s_memrealtime(); }
__device__ __forceinline__ unsigned f2bf(float f) { unsigned u = __builtin_bit_cast(unsigned, f); return (u + 0x7fffu + ((u >> 16) & 1u)) >> 16; }
__device__ __forceinline__ unsigned pk2(float lo, float hi) { return f2bf(lo) | (f2bf(hi) << 16); }

#define XB_TMO      128
#define XB_XCNT(j)  (256  + 64 * (j))
#define XB_XSUB(j)  (1280 + 64 * (j))
#define XB_XGEN(j)  (2304 + 64 * (j))
#define XB_TOP      3328
#define XB_TOPGEN   3392
#define XCD_BAR_WORDS 3456
#define XB_SPIN_CAP (1u << 18)

__device__ __forceinline__ unsigned xb_ld(unsigned* p)              { return __hip_atomic_load(p, __ATOMIC_RELAXED, __HIP_MEMORY_SCOPE_AGENT); }
__device__ __forceinline__ unsigned xb_add(unsigned* p, unsigned v) { return __hip_atomic_fetch_add(p, v, __ATOMIC_RELAXED, __HIP_MEMORY_SCOPE_AGENT); }
__device__ __forceinline__ unsigned xb_xcc_id() { return (unsigned)__builtin_amdgcn_s_getreg((3 << 11) | 20) & 0xFu; }
#define XB_SPIN(cond, bar) do { unsigned _sp = 0; while (cond) { __builtin_amdgcn_s_sleep(1); \
    if ((++_sp & 255u) == 0u) { if (xb_ld(&(bar)[XB_TMO])) break; if (_sp > XB_SPIN_CAP) { atomicAdd(&(bar)[XB_TMO], 1u); break; } } } } while (0)

struct XcdBarrier {
    unsigned* bar; unsigned x;
    volatile LAS unsigned* st;
};

__device__ __forceinline__ XcdBarrier xcd_barrier_post(unsigned* bar, volatile LAS unsigned* st) {
    XcdBarrier b; b.bar = bar; b.x = xb_xcc_id(); b.st = st;
    if (threadIdx.x == 0) (void)xb_add(&bar[XB_XCNT(b.x)], 1u);
    return b;
}
__device__ __forceinline__ void xcd_barrier_complete(unsigned* bar, unsigned x, unsigned& nloc, unsigned& nx) {
    const unsigned G = gridDim.x * gridDim.y * gridDim.z;
    unsigned sum, cnt, mine, sp = 0u;
    for (;;) {
        sum = 0u; cnt = 0u; mine = 0u;
#pragma unroll
        for (unsigned j = 0; j < 16; ++j) { const unsigned c = xb_ld(&bar[XB_XCNT(j)]); sum += c; cnt += (c > 0u) ? 1u : 0u; mine = (j == x) ? c : mine; }
        if (sum == G) break;
        __builtin_amdgcn_s_sleep(1);
        if ((++sp & 255u) == 0u) { if (xb_ld(&bar[XB_TMO])) break; if (sp > XB_SPIN_CAP) { atomicAdd(&bar[XB_TMO], 1u); break; } }
    }
    nloc = mine > 0u ? mine : 1u; nx = cnt > 0u ? cnt : 1u;
}

__device__ __forceinline__ void xcd_barrier(const XcdBarrier& b) {
    asm volatile("s_waitcnt vmcnt(0)" ::: "memory");
    __syncthreads();
    if (threadIdx.x == 0) {
        unsigned* bar = b.bar;
        __builtin_amdgcn_s_waitcnt(0);
        unsigned nloc = b.st[0], nx = b.st[1];
        if (nloc == 0u) { xcd_barrier_complete(bar, b.x, nloc, nx); b.st[0] = nloc; b.st[1] = nx; }
        const unsigned old = xb_add(&bar[XB_XSUB(b.x)], 1u);
        const unsigned gen = old / nloc;
        if (old + 1u == (gen + 1u) * nloc) {
            __builtin_amdgcn_fence(__ATOMIC_RELEASE, "agent");
            asm volatile("s_waitcnt vmcnt(0)" ::: "memory");
            const unsigned og = xb_add(&bar[XB_TOP], 1u);
            const unsigned tg = og / nx;
            if (og + 1u == (tg + 1u) * nx) xb_add(&bar[XB_TOPGEN], 1u);
            else XB_SPIN(xb_ld(&bar[XB_TOPGEN]) == tg, bar);
            __builtin_amdgcn_fence(__ATOMIC_ACQUIRE, "agent");
            xb_add(&bar[XB_XGEN(b.x)], 1u);
            asm volatile("s_waitcnt vmcnt(0)" ::: "memory");
        } else {
            XB_SPIN(xb_ld(&bar[XB_XGEN(b.x)]) == gen, bar);
            __builtin_amdgcn_fence(__ATOMIC_ACQUIRE, "agent");
            asm volatile("s_waitcnt vmcnt(0)" ::: "memory");
        }
    }
    __syncthreads();
}

constexpr int NWAVES = 8;
constexpr int NTOK = 16384, DM = 1024, DIN = 7168, DFF = 4096;
constexpr size_t MiB = 1u << 20;
constexpr size_t WS_CTL = 0, CTL_ZERO_BYTES = 64 * 1024;
constexpr size_t WS_MOD = 1 * MiB;
constexpr size_t WS_GMOD2 = WS_MOD + 96 * 1024;
constexpr size_t WS_BIAS2 = WS_MOD + 128 * 1024;
constexpr size_t WS_SPL = WS_MOD + 192 * 1024;
constexpr size_t WS_GW = WS_MOD + 256 * 1024;
constexpr size_t WS_AGG = 2 * MiB;
constexpr size_t WS_SSQ2 = 3 * MiB, WS_SSQ3 = 4 * MiB;
constexpr size_t WS_WIN = 6 * MiB, WS_WRG = 20 * MiB, WS_WSC = 22 * MiB, WS_WO = 24 * MiB, WS_W1 = 26 * MiB, WS_W2 = 34 * MiB;
constexpr size_t WS_R1 = 42 * MiB;
constexpr size_t WS_R2 = 74 * MiB;
constexpr size_t WS_R3 = 106 * MiB;
constexpr size_t WS_R4 = 138 * MiB;
constexpr size_t WS_R5 = 170 * MiB;
constexpr size_t WS_R6 = 202 * MiB;
constexpr size_t WS_HID = WS_R1;
constexpr size_t WS_END = 234 * MiB;
static_assert(WS_R5 == WS_R4 + (size_t)NTOK * DM * 2 && WS_WSC == WS_WRG + (size_t)DM * DM * 2 && WS_HID + (size_t)NTOK * DFF * 2 <= WS_R5, "ws map");
constexpr int CW_BAR = 4096;
constexpr int XT_STRIDE = 144, XT_BYTES = 256 * XT_STRIDE;
constexpr int LDS_MISC = 4 * XT_BYTES;
constexpr int LDS_BYTES = LDS_MISC + 512;
constexpr int NPH = 10;

typedef unsigned v2u __attribute__((ext_vector_type(2)));
typedef float f32x2 __attribute__((ext_vector_type(2)));
typedef float f32x16 __attribute__((ext_vector_type(16)));
__device__ __forceinline__ float bflo(unsigned w) { return __uint_as_float(w << 16); }
__device__ __forceinline__ float bfhi(unsigned w) { return __uint_as_float(w & 0xffff0000u); }
__device__ __forceinline__ float wave_sum(float v) {
#pragma unroll
    for (int o = 1; o < 64; o <<= 1) v += __shfl_xor(v, o);
    return v;
}
__device__ __forceinline__ float sigm_fast(float v) { return __builtin_amdgcn_rcpf(1.f + __builtin_amdgcn_exp2f(-1.4426950408889634f * v)); }

struct Args { const float* in[25]; float* out; unsigned char* ws; int ph_lo, ph_hi; };

__device__ __forceinline__ void p0_transpose_item(const float* W, int N, int src_n0, bf16* WT, int K, int dst_n0, int k0, LAS float* scr, int lane) {
#pragma unroll 8
    for (int i = 0; i < 32; ++i) { const int kk = 2 * i + (lane >> 5); scr[kk * 33 + (lane & 31)] = W[(size_t)(k0 + kk) * N + src_n0 + (lane & 31)]; }
    LDS_WAIT(); asm volatile("" ::: "memory");
    const int c = lane & 7;
#pragma unroll
    for (int j = 0; j < 4; ++j) { const int n = (lane >> 3) + 8 * j; const LAS float* s = scr + (8 * c) * 33 + n;
        v4u o; o.x = pk2(s[0 * 33], s[1 * 33]); o.y = pk2(s[2 * 33], s[3 * 33]); o.z = pk2(s[4 * 33], s[5 * 33]); o.w = pk2(s[6 * 33], s[7 * 33]);
        *(v4u*)(WT + (size_t)(dst_n0 + n) * K + k0 + 8 * c) = o; }
    LDS_WAIT(); asm volatile("" ::: "memory");
}
__device__ __forceinline__ int win_src_col(int nd) {
    if (nd < 3072 || nd >= 5120) return nd;
    const int q = nd - 3072, j = q >> 8, w = q & 255;
    return w < 128 ? 3072 + 128 * j + w : 4096 + 128 * j + (w - 128);
}
__device__ __forceinline__ void p0_phase(const Args& a, LAS unsigned char* lds, int tid, int wave, int lane, int vcu, int G) {
    unsigned char* ws = a.ws;
    {
        LAS float* sil = (LAS float*)lds;
        LAS float* part = (LAS float*)(lds + 16384);
        const float* c = a.in[3]; const float* c_ctx = a.in[4]; const float* ada_w = a.in[5]; const float* ada_b = a.in[6]; float* mod = (float*)(ws + WS_MOD);
        bool have = false;
        for (int it = vcu; it < 192; it += G) {
            if (!have) { for (int i = tid; i < 3072; i += 512) { const int r = i >> 10, k = i & 1023; const float v = r == 0 ? c_ctx[k] : c[(r - 1) * 1024 + k]; sil[i] = v / (1.f + __expf(-v)); } have = true; __syncthreads(); }
            const int n0 = 32 * it, col = lane & 31, ks = lane >> 5; float a0 = 0.f, a1 = 0.f, a2 = 0.f;
#pragma unroll 8
            for (int kk = 0; kk < 64; ++kk) { const int k = 128 * wave + 2 * kk + ks; const float wv = ada_w[(size_t)k * 6144 + n0 + col]; a0 += sil[k] * wv; a1 += sil[1024 + k] * wv; a2 += sil[2048 + k] * wv; }
            a0 += __shfl_xor(a0, 32); a1 += __shfl_xor(a1, 32); a2 += __shfl_xor(a2, 32);
            if (lane < 32) { part[(wave * 3 + 0) * 32 + col] = a0; part[(wave * 3 + 1) * 32 + col] = a1; part[(wave * 3 + 2) * 32 + col] = a2; }
            __syncthreads();
            if (tid < 96) { const int r = tid >> 5, cc = tid & 31; float s = ada_b[n0 + cc];
#pragma unroll
                for (int w = 0; w < 8; ++w) s += part[(w * 3 + r) * 32 + cc];
                mod[r * 6144 + n0 + cc] = s; }
            __syncthreads();
        }
        __syncthreads();
    }
    {
        LAS float* scr = (LAS float*)(lds + wave * 16384);
        const int gw = vcu * NWAVES + wave, NGW = G * NWAVES;
        constexpr int I_IN = 16 * 224, I_SQ = 16 * 32, I_1 = 16 * 128, I_2 = 64 * 32, NITEMS = I_IN + 3 * I_SQ + I_1 + I_2;
        for (int it = gw; it < NITEMS; it += NGW) {
            int r = it;
            if (r < I_IN) { const int kb = r / 224, nb = r % 224; p0_transpose_item(a.in[9], DIN, win_src_col(32 * nb), (bf16*)(ws + WS_WIN), DM, 32 * nb, 64 * kb, scr, lane); continue; } r -= I_IN;
            if (r < 3 * I_SQ) { const int which = r / I_SQ, q = r % I_SQ, kb = q / 32, nb = q % 32;
                const float* W = which == 0 ? a.in[18] : (which == 1 ? a.in[20] : a.in[21]); bf16* WT = (bf16*)(ws + (which == 0 ? WS_WRG : (which == 1 ? WS_WSC : WS_WO)));
                p0_transpose_item(W, DM, 32 * nb, WT, DM, 32 * nb, 64 * kb, scr, lane); continue; } r -= 3 * I_SQ;
            if (r < I_1) { const int kb = r / 128, nb = r % 128; p0_transpose_item(a.in[22], DFF, 32 * nb, (bf16*)(ws + WS_W1), DM, 32 * nb, 64 * kb, scr, lane); continue; } r -= I_1;
            { const int kb = r / 32, nb = r % 32; p0_transpose_item(a.in[23], DM, 32 * nb, (bf16*)(ws + WS_W2), DFF, 32 * nb, 64 * kb, scr, lane); }
        }
    }
    {
        bf16* GW = (bf16*)(ws + WS_GW); const float* wa = a.in[13]; const float* wx = a.in[15];
        for (int e = (vcu * 512 + tid); e < 262144 / 8; e += G * 512) {
            const int l = e & 63, s = (e >> 6) & 3, half = (e >> 8) & 1, gate = (e >> 9) & 1, dh = e >> 10;
            const float* W = (gate ? wx : wa) + (size_t)dh * 4096; const int i0 = 16 * s + 8 * (l >> 5), col = 32 * half + (l & 31);
            v4u o; o.x = pk2(W[(i0 + 0) * 64 + col], W[(i0 + 1) * 64 + col]); o.y = pk2(W[(i0 + 2) * 64 + col], W[(i0 + 3) * 64 + col]);
            o.z = pk2(W[(i0 + 4) * 64 + col], W[(i0 + 5) * 64 + col]); o.w = pk2(W[(i0 + 6) * 64 + col], W[(i0 + 7) * 64 + col]);
            *(v4u*)(GW + (size_t)e * 8) = o;
        }
    }
    {
        float* spl = (float*)(ws + WS_SPL); const float* lam = a.in[17];
        for (int e = vcu * 512 + tid; e < 2048; e += G * 512) { const float l = lam[e]; const float sp = (l < -20.f) ? -l : log1pf(expf(-l)); spl[e] = -8.f * sp * 1.4426950408889634f; }
    }
}

__device__ __forceinline__ void p1_phase(const Args& a, LAS unsigned char* lds, int tid, int wave, int lane, int vcu, int G) {
    unsigned char* ws = a.ws; const float* mod = (const float*)(ws + WS_MOD);
    {
        LAS float* sh = (LAS float*)lds;
        LAS float* part = (LAS float*)(lds + 16384);
        const float* w1 = a.in[22]; float* bias2 = (float*)(ws + WS_BIAS2); bool have = false;
        for (int it = vcu; it < 64; it += G) {
            if (!have) { for (int i = tid; i < 3072; i += 512) { const int r = i >> 10, k = i & 1023; sh[i] = mod[r * 6144 + 3 * DM + k]; } have = true; __syncthreads(); }
            const int n0 = 64 * it; float a0 = 0.f, a1 = 0.f, a2 = 0.f;
#pragma unroll 8
            for (int kk = 0; kk < 128; ++kk) { const int k = 128 * wave + kk; const float wv = w1[(size_t)k * DFF + n0 + lane]; a0 += sh[k] * wv; a1 += sh[1024 + k] * wv; a2 += sh[2048 + k] * wv; }
            part[(wave * 3 + 0) * 64 + lane] = a0; part[(wave * 3 + 1) * 64 + lane] = a1; part[(wave * 3 + 2) * 64 + lane] = a2;
            __syncthreads();
            if (tid < 192) { const int r = tid >> 6, cc = tid & 63; float s = 0.f;
#pragma unroll
                for (int w = 0; w < 8; ++w) s += part[(w * 3 + r) * 64 + cc];
                bias2[r * 4096 + n0 + cc] = s; }
            __syncthreads();
        }
        __syncthreads();
    }
    { float* gm = (float*)(ws + WS_GMOD2); const float* g2 = a.in[8];
      for (int e = vcu * 512 + tid; e < 3072; e += G * 512) { const int r = e >> 10, c = e & 1023; gm[e] = g2[c] * (1.f + mod[r * 6144 + 4 * DM + c]); } }
    {
        const int gw = vcu * NWAVES + wave, NGW = G * NWAVES; const float* g1 = a.in[7]; bf16* H1 = (bf16*)(ws + WS_R1);
        for (int m = gw; m < NTOK; m += NGW) {
            const float* xrow = m < 8192 ? a.in[0] + (size_t)m * DM : a.in[1] + (size_t)(m - 8192) * DM;
            const float* mr = mod + (m < 8192 ? 0 : 1 + ((m - 8192) >> 12)) * 6144;
            const f32x4* xr = (const f32x4*)xrow + lane; f32x4 v[4]; float s = 0.f;
#pragma unroll
            for (int j = 0; j < 4; ++j) { v[j] = xr[64 * j]; s += (v[j].x * v[j].x + v[j].y * v[j].y) + (v[j].z * v[j].z + v[j].w * v[j].w); }
            const float rs = 1.f / sqrtf(wave_sum(s) * (1.f / DM) + 1e-6f);
            unsigned long long* o8 = (unsigned long long*)(H1 + (size_t)m * DM) + lane;
#pragma unroll
            for (int j = 0; j < 4; ++j) { const int c = 256 * j + 4 * lane; const f32x4 g = *(const f32x4*)(g1 + c), sc = *(const f32x4*)(mr + DM + c), sh = *(const f32x4*)(mr + c);
                const f32x4 h = (v[j] * rs) * g * (sc + 1.f) + sh;
                o8[64 * j] = (unsigned long long)pk2(h.x, h.y) | ((unsigned long long)pk2(h.z, h.w) << 32); }
        }
    }
}

struct P3Ptrs { const bf16* XR; bf16* GGR; bf16* HS; const bf16* GW; const float *cw, *cb, *ba, *bx, *spl, *state; float* agg; float* newst; };

template <bool REV> __device__ __forceinline__ void block_scan(const float (&av)[16], float (&uv)[16], float& H, float& P, int kh) {
    float A4[4], B4[4], PA[4], PB[4];
#pragma unroll
    for (int g = 0; g < 4; ++g) {
        float aa, bb;
        if (!REV) { aa = av[4 * g]; bb = uv[4 * g];
#pragma unroll
            for (int j = 1; j < 4; ++j) { bb = av[4 * g + j] * bb + uv[4 * g + j]; aa *= av[4 * g + j]; } }
        else { aa = av[4 * g + 3]; bb = uv[4 * g + 3];
#pragma unroll
            for (int j = 2; j >= 0; --j) { bb = av[4 * g + j] * bb + uv[4 * g + j]; aa *= av[4 * g + j]; } }
        A4[g] = aa; B4[g] = bb; PA[g] = __shfl_xor(aa, 32); PB[g] = __shfl_xor(bb, 32);
    }
    float c = H, cin[4];
    const bool own_first = REV ? (kh == 1) : (kh == 0);
#pragma unroll
    for (int gi = 0; gi < 4; ++gi) { const int g = REV ? 3 - gi : gi;
        const float FA = own_first ? A4[g] : PA[g], FB = own_first ? B4[g] : PB[g], SA = own_first ? PA[g] : A4[g], SB = own_first ? PB[g] : B4[g];
        const float c1 = FA * c + FB, c2 = SA * c1 + SB; cin[g] = own_first ? c : c1; c = c2; P *= A4[g] * PA[g]; }
    H = c;
#pragma unroll
    for (int g = 0; g < 4; ++g) { float h = cin[g];
        if (!REV) {
#pragma unroll
            for (int j = 0; j < 4; ++j) { h = av[4 * g + j] * h + uv[4 * g + j]; uv[4 * g + j] = h; } }
        else {
#pragma unroll
            for (int j = 3; j >= 0; --j) { h = av[4 * g + j] * h + uv[4 * g + j]; uv[4 * g + j] = h; } } }
}

__device__ __forceinline__ void p3_unit(const P3Ptrs& p, LAS unsigned char* lds, int pm, int hg, int mode, int tid, int wid, int lane) {
    const bool ctx = pm < 32;
    {
        const int cp = tid & 127, tg = tid >> 7, ch = hg * 256 + 2 * cp;
        f32x2 w0 = *(const f32x2*)(p.cw + ch), w1 = *(const f32x2*)(p.cw + 1024 + ch), w2 = *(const f32x2*)(p.cw + 2048 + ch), w3 = *(const f32x2*)(p.cw + 3072 + ch), bb = *(const f32x2*)(p.cb + ch);
        const bf16* xr = p.XR + (size_t)(pm * 256 + tg * 64) * DM + ch;
#define LDX(ptr) ({ const unsigned _w = *(const unsigned*)(ptr); (f32x2){bflo(_w), bfhi(_w)}; })
        f32x2 xm2 = (f32x2){0.f, 0.f}, xm1 = xm2, x0, xp1;
        if (ctx && tg > 0) { xm2 = LDX(xr - 2 * DM); xm1 = LDX(xr - DM); }
        x0 = LDX(xr);
        LAS unsigned char* dst = lds + (cp >> 5) * XT_BYTES + (tg * 64) * XT_STRIDE + (cp & 31) * 4;
#pragma unroll 8
        for (int t = 0; t < 63; ++t) { xp1 = LDX(xr + (size_t)(t + 1) * DM);
            const f32x2 y = bb + w0 * xm2 + w1 * xm1 + w2 * x0 + w3 * xp1;
            *(LAS unsigned*)(dst + t * XT_STRIDE) = pk2(y.x, y.y); xm2 = xm1; xm1 = x0; x0 = xp1; }
        xp1 = (f32x2){0.f, 0.f}; if (ctx && tg < 3) xp1 = LDX(xr + (size_t)64 * DM);
        { const f32x2 y = bb + w0 * xm2 + w1 * xm1 + w2 * x0 + w3 * xp1; *(LAS unsigned*)(dst + 63 * XT_STRIDE) = pk2(y.x, y.y); }
#undef LDX
    }
    __syncthreads();
    const int hl = wid >> 1, half = wid & 1, head = hg * 4 + hl, cb32 = hg * 8 + wid, cl = lane & 31, kh = lane >> 5, ch = cb32 * 32 + cl;
    const LAS unsigned char* xt = lds + hl * XT_BYTES;
    bf16x8 Id0, Id1;
#pragma unroll
    for (int j = 0; j < 8; ++j) { Id0[j] = (cl == 8 * kh + j) ? (short)0x3F80 : (short)0; Id1[j] = (cl == 16 + 8 * kh + j) ? (short)0x3F80 : (short)0; }
    const int seq = ctx ? 0 : (pm - 32) >> 4, tj = ctx ? 0 : (pm - 32) & 15;
#pragma unroll 1
    for (int d = 0; d < 2; ++d) {
        const float ba = p.ba[d * DM + ch], bx = p.bx[d * DM + ch], spl = p.spl[d * DM + ch];
        bf16x8 Wa[4], Wx[4];
#pragma unroll
        for (int s = 0; s < 4; ++s) { Wa[s] = *(const bf16x8*)(p.GW + ((size_t)((((d * 16 + head) * 2 + 0) * 2 + half) * 4 + s) * 64 + lane) * 8);
                                      Wx[s] = *(const bf16x8*)(p.GW + ((size_t)((((d * 16 + head) * 2 + 1) * 2 + half) * 4 + s) * 64 + lane) * 8); }
        float H = 0.f, P = 1.f;
        if (mode == 2) { H = p.state[(seq * 2 + d) * DM + ch];
            if (d == 0) { for (int j = 0; j < tj; ++j) { const f32x2 ab = *(const f32x2*)(p.agg + ((size_t)((seq * 16 + j) * 2 + 0) * DM + ch) * 2); H = ab.x * H + ab.y; } }
            else { for (int j = 15; j > tj; --j) { const f32x2 ab = *(const f32x2*)(p.agg + ((size_t)((seq * 16 + j) * 2 + 1) * DM + ch) * 2); H = ab.x * H + ab.y; } } }
#pragma unroll 1
        for (int bi = 0; bi < 8; ++bi) { const int b = d ? 7 - bi : bi;
            bf16x8 Af[4];
#pragma unroll
            for (int s = 0; s < 4; ++s) Af[s] = *(const LAS bf16x8*)(xt + (32 * b + cl) * XT_STRIDE + 32 * s + 16 * kh);
            f32x16 aR, aI, aX;
#pragma unroll
            for (int r = 0; r < 16; ++r) { aR[r] = 0.f; aI[r] = 0.f; aX[r] = 0.f; }
#pragma unroll
            for (int s = 0; s < 4; ++s) { aR = __builtin_amdgcn_mfma_f32_32x32x16_bf16(Af[s], Wa[s], aR, 0, 0, 0); aI = __builtin_amdgcn_mfma_f32_32x32x16_bf16(Af[s], Wx[s], aI, 0, 0, 0); }
            if (half) { aX = __builtin_amdgcn_mfma_f32_32x32x16_bf16(Af[2], Id0, aX, 0, 0, 0); aX = __builtin_amdgcn_mfma_f32_32x32x16_bf16(Af[3], Id1, aX, 0, 0, 0); }
            else      { aX = __builtin_amdgcn_mfma_f32_32x32x16_bf16(Af[0], Id0, aX, 0, 0, 0); aX = __builtin_amdgcn_mfma_f32_32x32x16_bf16(Af[1], Id1, aX, 0, 0, 0); }
            float av[16], uv[16];
#pragma unroll
            for (int r = 0; r < 16; ++r) {
                const float rg = sigm_fast(aR[r] + ba), ig = sigm_fast(aI[r] + bx);
                const float e = rg * spl;
                const float a1 = __builtin_amdgcn_exp2f(e);
                const float z = e * 1.3862943611198906f;
                const float om_s = -(z * (1.f + z * (0.5f + z * (0.16666667f + z * 0.041666668f))));
                const float om = (z > -0.125f) ? om_s : (1.f - a1 * a1);
                av[r] = a1; uv[r] = __builtin_amdgcn_sqrtf(om) * (ig * aX[r]);
            }
            if (d == 0) block_scan<false>(av, uv, H, P, kh); else block_scan<true>(av, uv, H, P, kh);
            if (mode != 1) {
                bf16* hs = p.HS + ((size_t)((pm * 32 + cb32) * 8 + b) * 64 + lane) * 16;
                if (d == 0) {
                    v4u o0, o1; o0.x = pk2(uv[0], uv[1]); o0.y = pk2(uv[2], uv[3]); o0.z = pk2(uv[4], uv[5]); o0.w = pk2(uv[6], uv[7]);
                    o1.x = pk2(uv[8], uv[9]); o1.y = pk2(uv[10], uv[11]); o1.z = pk2(uv[12], uv[13]); o1.w = pk2(uv[14], uv[15]);
                    *(v4u*)hs = o0; *(v4u*)(hs + 8) = o1;
                } else {
                    const v4u i0 = *(const v4u*)hs, i1 = *(const v4u*)(hs + 8);
                    const unsigned hw[8] = {i0.x, i0.y, i0.z, i0.w, i1.x, i1.y, i1.z, i1.w};
                    bf16* gp = p.GGR + (size_t)(pm * 256 + 32 * b + 4 * kh) * DM + ch;
#pragma unroll
                    for (int r = 0; r < 16; ++r) { const int tok = (r & 3) + 8 * (r >> 2); const float hf = (r & 1) ? bfhi(hw[r >> 1]) : bflo(hw[r >> 1]);
                        bf16* q = gp + (size_t)tok * DM; const float g = __uint_as_float(((unsigned)*q) << 16); *q = (bf16)f2bf((hf + uv[r]) * g); }
                }
            }
        }
        if (kh == 0) {
            if (mode == 0) p.newst[(size_t)(pm * 2 + d) * DM + ch] = H;
            if (mode == 1) *(f32x2*)(p.agg + ((size_t)((seq * 16 + tj) * 2 + d) * DM + ch) * 2) = (f32x2){P, H};
        }
    }
    __syncthreads();
}

__device__ __forceinline__ void p3_branch_b_item(const bf16* T, bf16* SB, const float* wsc, int tb, int tid) {
    const int c8 = tid & 127, tq = tid >> 7, ch = 8 * c8, tok0 = 64 * tb + 16 * tq; const bool ctx = tb < 128;
    float w0[8], w1[8], w2[8];
#pragma unroll
    for (int j = 0; j < 8; ++j) { w0[j] = wsc[ch + j]; w1[j] = wsc[1024 + ch + j]; w2[j] = wsc[2048 + ch + j]; }
    const bf16* tp = T + (size_t)tok0 * DM + ch; bf16* sp = SB + (size_t)tok0 * DM + ch;
    const v4u zero = (v4u){0u, 0u, 0u, 0u};
    v4u prev = zero, cur, nxt;
    if (tq > 0 || (ctx && (tb & 3) != 0)) prev = *(const v4u*)(tp - DM);
    cur = *(const v4u*)tp;
    const bool tail = (tq < 3) || (ctx && (tb & 3) != 3);
#pragma unroll 4
    for (int i = 0; i < 16; ++i) {
        nxt = zero; if (i < 15 || tail) nxt = *(const v4u*)(tp + (size_t)(i + 1) * DM);
        const v4u sv = *(const v4u*)(sp + (size_t)i * DM);
        const unsigned pw[4] = {prev.x, prev.y, prev.z, prev.w}, cw[4] = {cur.x, cur.y, cur.z, cur.w}, nw[4] = {nxt.x, nxt.y, nxt.z, nxt.w}, sw[4] = {sv.x, sv.y, sv.z, sv.w};
        unsigned ow[4];
#pragma unroll
        for (int q = 0; q < 4; ++q) {
            const float y0 = w0[2 * q] * bflo(pw[q]) + w1[2 * q] * bflo(cw[q]) + w2[2 * q] * bflo(nw[q]);
            const float y1 = w0[2 * q + 1] * bfhi(pw[q]) + w1[2 * q + 1] * bfhi(cw[q]) + w2[2 * q + 1] * bfhi(nw[q]);
            ow[q] = pk2(bflo(sw[q]) * y0, bfhi(sw[q]) * y1); }
        *(v4u*)(sp + (size_t)i * DM) = (v4u){ow[0], ow[1], ow[2], ow[3]};
        prev = cur; cur = nxt;
    }
}

__device__ __forceinline__ void p8_phase(float* X, const float* SSQ, const float* fg, int wave, int lane, int vcu, int G) {
    const int gw = vcu * NWAVES + wave, NGW = G * NWAVES;
    for (int m = gw; m < NTOK; m += NGW) {
        const f32x4* sp = (const f32x4*)(SSQ + (size_t)m * 16); const f32x4 s0 = sp[0], s1 = sp[1], s2 = sp[2], s3 = sp[3];
        const float tot = ((s0[0] + s0[1]) + (s0[2] + s0[3])) + ((s1[0] + s1[1]) + (s1[2] + s1[3])) + ((s2[0] + s2[1]) + (s2[2] + s2[3])) + ((s3[0] + s3[1]) + (s3[2] + s3[3]));
        const float rs = 1.f / sqrtf(tot * (1.f / DM) + 1e-6f);
        f32x4* xr = (f32x4*)(X + (size_t)m * DM) + lane;
#pragma unroll
        for (int j = 0; j < 4; ++j) { const f32x4 g = *(const f32x4*)(fg + 256 * j + 4 * lane); xr[64 * j] = xr[64 * j] * rs * g; }
    }
}

#ifndef MK_PER_PHASE
#define MK_PER_PHASE 0
#endif
__global__ void __launch_bounds__(NWAVES * 64, 2) mk_fwd(Args args) {
    extern __shared__ __attribute__((aligned(16))) unsigned char lds_raw[];
    LAS unsigned char* lds = (LAS unsigned char*)lds_raw;
    volatile LAS unsigned* MISC = (volatile LAS unsigned*)(lds + LDS_MISC);
    const int tid = threadIdx.x, lane = tid & 63, wave = __builtin_amdgcn_readfirstlane(tid >> 6);
    const int G = gridDim.x; const int bx = blockIdx.x; const int vcu = (G % 8 == 0) ? (bx % 8) * (G / 8) + bx / 8 : bx;
    unsigned char* ws = args.ws;
    for (int u = tid; u < (LDS_BYTES - LDS_MISC) / 4; u += NWAVES * 64) ((LAS unsigned*)(lds + LDS_MISC))[u] = 0u;
    __syncthreads();
    XcdBarrier bar; bar.bar = (unsigned*)(ws + WS_CTL) + CW_BAR; bar.x = 0; bar.st = nullptr;
    if (!MK_PER_PHASE) bar = xcd_barrier_post((unsigned*)(ws + WS_CTL) + CW_BAR, MISC + 8);
#define GRID_BAR() do { if (!MK_PER_PHASE) xcd_barrier(bar); } while (0)
    const int lo = args.ph_lo, hi = args.ph_hi;
#define IN(k) (lo <= (k) && (k) < hi)
#define BOTH(k) (IN(k) && IN((k) + 1))
    bf16* const R1 = (bf16*)(ws + WS_R1); bf16* const R2 = (bf16*)(ws + WS_R2); bf16* const R3 = (bf16*)(ws + WS_R3); bf16* const R4 = (bf16*)(ws + WS_R4); bf16* const R5 = (bf16*)(ws + WS_R5); bf16* const R6 = (bf16*)(ws + WS_R6);
    const float* mod = (const float*)(ws + WS_MOD);

    if (IN(0)) { p0_phase(args, lds, tid, wave, lane, vcu, G); if (BOTH(0)) GRID_BAR(); }
    if (IN(1)) { p1_phase(args, lds, tid, wave, lane, vcu, G); if (BOTH(1)) GRID_BAR(); }
    if (IN(2)) {
        pg8::Gemm g{R1, (const bf16*)(ws + WS_WIN), NTOK, DIN, DM}; pg8::StaticOrder S; S.init(NTOK, DIN, G, bx);
        pg8::EpiG1 E{R2, R4, R5, R3, (bf16*)args.out, args.in[10]};
        pg8::gemm_phase<pg8::EpiG1, pg8::StaticOrder, true, true>(lds, g, S, E);
        if (BOTH(2)) GRID_BAR();
    }
    if (IN(3) || IN(4)) {
        P3Ptrs p{R2, R4, R1, (const bf16*)(ws + WS_GW), args.in[11], args.in[12], args.in[14], args.in[16], (const float*)(ws + WS_SPL), args.in[2], (float*)(ws + WS_AGG), args.out + (size_t)NTOK * DM};
        if (IN(3)) {
            for (int u = vcu; u < 256; u += G) { const int pm = u >> 2, hg = u & 3; p3_unit(p, lds, pm, hg, pm < 32 ? 0 : 1, tid, wave, lane); }
            if (BOTH(3)) GRID_BAR();
        }
        if (IN(4)) {
            const int nA = G >= 2 ? G / 2 : 1;
            if (vcu < nA) { for (int u = vcu; u < 128; u += nA) { const int pm = 32 + (u >> 2), hg = u & 3; p3_unit(p, lds, pm, hg, 2, tid, wave, lane); } }
            if (G >= 2) { if (vcu >= nA) for (int tb = vcu - nA; tb < 256; tb += G - nA) p3_branch_b_item(R3, R5, args.in[19], tb, tid); }
            else for (int tb = 0; tb < 256; ++tb) p3_branch_b_item(R3, R5, args.in[19], tb, tid);
            if (BOTH(4)) GRID_BAR();
        }
    }
    if (IN(5)) {
        pg8::Gemm g{R4, (const bf16*)(ws + WS_WRG), 2 * NTOK, 2 * DM, DM}; pg8::PairOrder S; S.base.init(NTOK, DM, G, bx);
        pg8::EpiG2 E{(const bf16*)args.out, (float*)(ws + WS_R2), R1};
        pg8::gemm_phase<pg8::EpiG2, pg8::PairOrder, true, true>(lds, g, S, E);
        if (BOTH(5)) GRID_BAR();
    }
    if (IN(6)) {
        pg8::Gemm g{R1, (const bf16*)(ws + WS_WO), NTOK, DM, DM}; pg8::StaticOrder S; S.init(NTOK, DM, G, bx);
        pg8::EpiG3 E{args.in[0], args.in[1], mod, (const float*)(ws + WS_GMOD2), args.out, R6, (float*)(ws + WS_SSQ2)};
        pg8::gemm_phase<pg8::EpiG3, pg8::StaticOrder, true, true>(lds, g, S, E);
        if (BOTH(6)) GRID_BAR();
    }
    if (IN(7)) {
        pg8::Gemm g{R6, (const bf16*)(ws + WS_W1), NTOK, DFF, DM}; pg8::StaticOrder S; S.init(NTOK, DFF, G, bx);
        pg8::EpiG4 E{(const float*)(ws + WS_SSQ2), (const float*)(ws + WS_BIAS2), (bf16*)(ws + WS_HID)};
        pg8::gemm_phase<pg8::EpiG4, pg8::StaticOrder, true, true>(lds, g, S, E);
        if (BOTH(7)) GRID_BAR();
    }
    if (IN(8)) {
        pg8::Gemm g{(const bf16*)(ws + WS_HID), (const bf16*)(ws + WS_W2), NTOK, DM, DFF}; pg8::StaticOrder S; S.init(NTOK, DM, G, bx);
        pg8::EpiG5 E{args.out, mod, (float*)(ws + WS_SSQ3)};
        pg8::gemm_phase<pg8::EpiG5, pg8::StaticOrder, true, true>(lds, g, S, E);
        if (BOTH(8)) GRID_BAR();
    }
    if (IN(9)) p8_phase(args.out, (const float*)(ws + WS_SSQ3), args.in[24], wave, lane, vcu, G);
#undef IN
#undef BOTH
}

#ifndef MK_DIGEST
#define MK_DIGEST -1
#endif
#ifndef MK_DIGEST_SEL
#define MK_DIGEST_SEL 20
#endif
__global__ void k_digest1(const unsigned char* ws, const float* out, float* dg, int k) {
    const bf16* R1 = (const bf16*)(ws + WS_R1); const bf16* R2 = (const bf16*)(ws + WS_R2); const bf16* R3 = (const bf16*)(ws + WS_R3); const bf16* R4 = (const bf16*)(ws + WS_R4); const bf16* R5 = (const bf16*)(ws + WS_R5); const bf16* R6 = (const bf16*)(ws + WS_R6);
    const size_t n4 = (size_t)NTOK * DM / 4;
    auto f = [](bf16 b) { return __uint_as_float(((unsigned)b) << 16); };
    for (size_t i = (size_t)blockIdx.x * 256 + threadIdx.x; i < n4; i += (size_t)gridDim.x * 256) {
        float v = 0.f;
        for (int j = 0; j < 4; ++j) { const size_t e = 4 * i + j;
            if (k == 1) v += f(R1[e]);
            else if (k == 2) { const bf16* G = (const bf16*)out; v += f(R2[e]) + f(R3[e]) + f(R4[e]) + f(R5[e]) + f(G[2 * e]) + f(G[2 * e + 1]); }
            else if (k == 20) { const bf16* G = (const bf16*)out; v += f(G[2 * e]) + f(G[2 * e + 1]); }
            else if (k == 4) v += f(R4[e]) + f(R5[e]);
            else if (k == 5) v += f(R1[e]);
            else if (k == 6) v += out[e] + f(R6[e]);
            else if (k == 7) { const bf16* H = (const bf16*)(ws + WS_HID); v += f(H[4 * e]) + f(H[4 * e + 1]) + f(H[4 * e + 2]) + f(H[4 * e + 3]); }
            else v += out[e]; }
        dg[i] = v;
    }
}
__global__ void k_digest2(const float* dg, float* out, size_t n) { const size_t n4 = (size_t)NTOK * DM / 4; for (size_t i = (size_t)blockIdx.x * 256 + threadIdx.x; i < n; i += (size_t)gridDim.x * 256) out[i] = dg[i % n4]; }
extern "C" void kernel_launch(void* const* d_in, const int* in_sizes, int n_in, void* d_out, int out_size, void* d_ws, size_t ws_size, hipStream_t stream) {
    static int grid = 0;
    if (grid == 0) {
        if (n_in != 25 || out_size != NTOK * DM + 32 * 2 * DM || ws_size < WS_END) { fprintf(stderr, "kernel_launch: unexpected problem (n_in %d, out %d, ws %zu); nothing launched\n", n_in, out_size, ws_size); grid = -1; return; }
        int dev = 0, cus = 0, per_cu = 0;
        if (hipGetDevice(&dev) != hipSuccess || hipDeviceGetAttribute(&cus, hipDeviceAttributeMultiprocessorCount, dev) != hipSuccess) { grid = -1; return; }
        if (hipFuncSetAttribute((const void*)mk_fwd, hipFuncAttributeMaxDynamicSharedMemorySize, LDS_BYTES) != hipSuccess) { fprintf(stderr, "kernel_launch: hipFuncSetAttribute failed\n"); grid = -1; return; }
        if (hipOccupancyMaxActiveBlocksPerMultiprocessor(&per_cu, (const void*)mk_fwd, NWAVES * 64, LDS_BYTES) != hipSuccess || per_cu < 1) { fprintf(stderr, "kernel_launch: occupancy query says %d blocks per CU\n", per_cu); }
        (void)hipGetLastError();
        grid = cus;
    }
    if (grid < 0) return;
    Args a{};
    for (int i = 0; i < 25; ++i) a.in[i] = (const float*)d_in[i];
    a.out = (float*)d_out; a.ws = (unsigned char*)d_ws;
#if MK_PER_PHASE
    for (int k = 0; k < NPH; ++k) { if (MK_DIGEST >= 0 && k > MK_DIGEST) break; a.ph_lo = k; a.ph_hi = k + 1; hipLaunchKernelGGL(mk_fwd, dim3(grid), dim3(NWAVES * 64), LDS_BYTES, stream, a); }
    if (MK_DIGEST >= 0) { float* dg = (float*)((char*)d_ws + WS_END);
        hipLaunchKernelGGL(k_digest1, dim3(1024), dim3(256), 0, stream, (const unsigned char*)d_ws, (const float*)d_out, dg, (int)MK_DIGEST_SEL);
        hipLaunchKernelGGL(k_digest2, dim3(1024), dim3(256), 0, stream, (const float*)dg, (float*)d_out, (size_t)out_size); }
#else
    if (hipMemsetAsync((char*)d_ws + WS_CTL, 0, CTL_ZERO_BYTES, stream) != hipSuccess) { fprintf(stderr, "kernel_launch: memset failed\n"); return; }
    a.ph_lo = 0; a.ph_hi = NPH;
    hipLaunchKernelGGL(mk_fwd, dim3(grid), dim3(NWAVES * 64), LDS_BYTES, stream, a);
#endif
}
```
